# Optimizing an MI355X kernel written in HIP

```python
import math
import jax, jax.numpy as jnp
from jax import lax
import numpy as np

D_MODEL = 1024
BATCH = 4
SEQ = 8192
DEPTH = 1

D_A = D_MODEL
D_B = D_MODEL
CONV_A_WIDTH = 3
CONV_B_WIDTH = 31
D_FF = 4 * D_MODEL
N_GROUPS = 16
LN_EPS = 1e-5
ALPHA = (2.0 * DEPTH) ** 0.25
BETA = (8.0 * DEPTH) ** -0.25
W_IN_COLS = 3 * D_A + 2 * D_B + 2 * D_MODEL

kernel_name = "hybrid_shortconv_conformer_gated_deepnorm"


def layernorm(x, gamma, beta):
    xf = x.astype(jnp.float32)
    mu = jnp.mean(xf, axis=-1, keepdims=True)
    var = jnp.mean(jnp.square(xf - mu), axis=-1, keepdims=True)
    y = (xf - mu) * lax.rsqrt(var + LN_EPS)
    y = y * gamma.astype(jnp.float32) + beta.astype(jnp.float32)
    return y.astype(x.dtype)


def causal_depthwise_conv(x, w):
    k = w.shape[0]
    c = x.shape[-1]
    return lax.conv_general_dilated(
        x, w[:, None, :].astype(x.dtype),
        window_strides=(1,),
        padding=[(k - 1, 0)],
        dimension_numbers=("NWC", "WIO", "NWC"),
        feature_group_count=c,
    )


def setup_inputs(seed: int = 0) -> dict:
    key = jax.random.key(seed)
    ks = jax.random.split(key, 20)
    f32 = jnp.float32
    nrm = lambda k, shape, scale: jax.random.normal(k, shape, f32) * scale
    return {
        "x": jax.random.normal(ks[0], (BATCH, SEQ, D_MODEL), f32),
        "w_in": nrm(ks[1], (D_MODEL, W_IN_COLS), D_MODEL ** -0.5),
        "conv_a_w": nrm(ks[2], (CONV_A_WIDTH, D_A), CONV_A_WIDTH ** -0.5),
        "w_out_a": nrm(ks[3], (D_A, D_MODEL), BETA * D_A ** -0.5),
        "conv_b_w": nrm(ks[4], (CONV_B_WIDTH, D_B), CONV_B_WIDTH ** -0.5),
        "conv_b_bias": nrm(ks[5], (D_B,), 0.02),
        "ln_b_gamma": 1.0 + nrm(ks[6], (D_B,), 0.02),
        "ln_b_beta": nrm(ks[7], (D_B,), 0.02),
        "w_out_b": nrm(ks[8], (D_B, D_MODEL), BETA * D_B ** -0.5),
        "w_o": nrm(ks[9], (D_MODEL, D_MODEL), BETA * D_MODEL ** -0.5),
        "ln1_gamma": 1.0 + nrm(ks[10], (D_MODEL,), 0.02),
        "ln1_beta": nrm(ks[11], (D_MODEL,), 0.02),
        "w_up": nrm(ks[12], (D_MODEL, D_FF), D_MODEL ** -0.5),
        "w_down": nrm(ks[13], (D_FF, D_MODEL), BETA * D_FF ** -0.5),
        "ln2_gamma": 1.0 + nrm(ks[14], (D_MODEL,), 0.02),
        "ln2_beta": nrm(ks[15], (D_MODEL,), 0.02),
    }


def token_mixer(x, w_in, conv_a_w, w_out_a, conv_b_w, conv_b_bias,
                ln_b_gamma, ln_b_beta, w_out_b, w_o):
    p = jnp.einsum("bsd,dc->bsc", x, w_in)
    splits = np.cumsum([D_A, D_A, D_A, D_B, D_B, D_MODEL])
    b_a, c_a, v_a, val_b, gate_b, g_a, g_b = jnp.split(p, splits, axis=-1)

    y_a = b_a * causal_depthwise_conv(c_a * v_a, conv_a_w)
    y_a = jnp.einsum("bsc,cd->bsd", y_a, w_out_a)

    u = val_b * jax.nn.sigmoid(gate_b)
    u = causal_depthwise_conv(u, conv_b_w) + conv_b_bias.astype(u.dtype)
    u = jax.nn.silu(layernorm(u, ln_b_gamma, ln_b_beta))
    y_b = jnp.einsum("bsc,cd->bsd", u, w_out_b)

    merged = jax.nn.sigmoid(g_a) * y_a + jax.nn.sigmoid(g_b) * y_b
    return jnp.einsum("bsd,de->bse", merged, w_o)


def channel_mixer(x, w_up, w_down):
    h = jnp.square(jax.nn.relu(jnp.einsum("bsd,df->bsf", x, w_up)))
    return jnp.einsum("bsf,fd->bsd", h, w_down)


def reference(x, w_in, conv_a_w, w_out_a, conv_b_w, conv_b_bias, ln_b_gamma,
              ln_b_beta, w_out_b, w_o, ln1_gamma, ln1_beta, w_up, w_down,
              ln2_gamma, ln2_beta):
    alpha = jnp.asarray(ALPHA, dtype=x.dtype)
    for _ in range(DEPTH):
        mix = token_mixer(x, w_in, conv_a_w, w_out_a, conv_b_w, conv_b_bias,
                          ln_b_gamma, ln_b_beta, w_out_b, w_o)
        x = layernorm(alpha * x + mix, ln1_gamma, ln1_beta)
        ff = channel_mixer(x, w_up, w_down)
        x = layernorm(alpha * x + ff, ln2_gamma, ln2_beta)
    return x
```

```cpp
#include <hip/hip_runtime.h>
#include <hip/hip_cooperative_groups.h>
#include <cstdio>
#include <cstdint>
namespace cg = cooperative_groups;

namespace pg8 {
#define PG8_LAS __attribute__((address_space(3)))
typedef unsigned short bf16_t;
typedef short bf16x8 __attribute__((ext_vector_type(8)));
typedef float f32x4 __attribute__((ext_vector_type(4)));
typedef float f32x2 __attribute__((ext_vector_type(2)));
typedef unsigned u32x4 __attribute__((ext_vector_type(4)));
constexpr int BM = 256, BK = 64, HALF = 128, HTB = HALF * BK * 2, STAGE_BYTES = 8 * HTB, NXCD = 8, WGM = 8;

__host__ __device__ __forceinline__ int lds_byte(int r, int c) { const int st = (r >> 4) * 2 + (c >> 5), rr = r & 15, cc = c & 31, ob = rr * 64 + cc * 2; return st * 1024 + (ob ^ (((ob >> 9) & 1) << 5)); }
__host__ __device__ __forceinline__ void stage_rc(int b, int& R, int& C) { const int st = b / 1024, sb = b % 1024, swz = sb ^ (((sb >> 9) & 1) << 5); R = (st >> 1) * 16 + swz / 64; C = (st & 1) * 32 + (swz % 64) / 2; }
__host__ __device__ __forceinline__ int perm32(int rho) { const int n = rho >> 4, i = rho & 15; return 8 * (i >> 2) + 4 * n + (i & 3); }

struct Unit { int pm, pn; };
struct Gemm { const bf16_t* A; const bf16_t* Bt; int M, N, K, lda, ldb; };

struct StaticOrder {
    int nM, nN, nwg, G, c;
    __host__ __device__ void init(int M, int N, int G_, int c_) { nM = M / BM; nN = N / BM; nwg = nM * nN; G = G_; c = c_; }
    __host__ __device__ bool next(int i, Unit& u) const {
        const long L = (long)i * G + c; if (L >= nwg) return false;
        int wgid = (int)L; { const int q = nwg / NXCD, r = nwg % NXCD, xcd = wgid % NXCD, off = wgid / NXCD; wgid = (xcd < r ? xcd * (q + 1) : r * (q + 1) + (xcd - r) * q) + off; }
        const int nig = WGM * nN, gid = wgid / nig, fm = gid * WGM, gsz = (nM - fm) < WGM ? (nM - fm) : WGM;
        u.pm = fm + ((wgid % nig) % gsz); u.pn = (wgid % nig) / gsz; return true;
    }
};

__device__ __forceinline__ unsigned cvt_pk_bf16(float lo, float hi) { unsigned r; asm volatile("v_cvt_pk_bf16_f32 %0, %1, %2" : "=v"(r) : "v"(lo), "v"(hi)); return r; }
__device__ __forceinline__ float sigm(float x) { return __builtin_amdgcn_rcpf(1.0f + __builtin_amdgcn_exp2f(-1.4426950408889634f * x)); }
__device__ __forceinline__ f32x4 sigm4(f32x4 v) { return (f32x4){sigm(v[0]), sigm(v[1]), sigm(v[2]), sigm(v[3])}; }
__device__ __forceinline__ u32x4 pack8(f32x4 v0, f32x4 v1) { u32x4 w; w.x = cvt_pk_bf16(v0[0], v0[1]); w.y = cvt_pk_bf16(v0[2], v0[3]); w.z = cvt_pk_bf16(v1[0], v1[1]); w.w = cvt_pk_bf16(v1[2], v1[3]); return w; }
__device__ __forceinline__ void unpack8(u32x4 w, f32x4& v0, f32x4& v1) {
    v0[0] = __uint_as_float(w.x << 16); v0[1] = __uint_as_float(w.x & 0xffff0000u); v0[2] = __uint_as_float(w.y << 16); v0[3] = __uint_as_float(w.y & 0xffff0000u);
    v1[0] = __uint_as_float(w.z << 16); v1[1] = __uint_as_float(w.z & 0xffff0000u); v1[2] = __uint_as_float(w.w << 16); v1[3] = __uint_as_float(w.w & 0xffff0000u);
}

struct EpiP1 {
    static constexpr bool PERM = true, AFTER_DRAIN = false;
    bf16_t* P5; size_t seg; int ldc;
    __device__ __forceinline__ void operator()(const f32x4 (&acc)[2][2][4][2], const Unit& u, int wr, int wc, int fr, int fq) const {
        const int row0 = u.pm * BM + wr * 64 + fr, pn = u.pn;
        if (pn < 4 || pn >= 20) {
            bf16_t* base = P5 + (pn < 4 ? (size_t)0 : (pn < 24 ? 3 * seg : 4 * seg)); const int colt = pn < 4 ? pn * 256 : (pn < 24 ? (pn - 20) * 256 : (pn - 24) * 256); const bool sg = pn >= 20;
            const int col0 = colt + wc * 32 + 8 * fq;
#pragma unroll
            for (int ai = 0; ai < 2; ++ai)
#pragma unroll
                for (int m = 0; m < 4; ++m) { bf16_t* rowp = base + (size_t)(row0 + ai * HALF + m * 16) * ldc + col0;
#pragma unroll
                    for (int bj = 0; bj < 2; ++bj) { f32x4 v0 = acc[ai][bj][m][0], v1 = acc[ai][bj][m][1];
                        if (sg) { v0 = sigm4(v0); v1 = sigm4(v1); }
                        *(u32x4*)(rowp + bj * HALF) = pack8(v0, v1); } }
        } else {
            const bool glu = pn >= 12; bf16_t* base = P5 + (glu ? 2 * seg : seg); const int t = glu ? pn - 12 : pn - 4; const int col0 = t * 128 + wc * 32 + 8 * fq;
#pragma unroll
            for (int ai = 0; ai < 2; ++ai)
#pragma unroll
                for (int m = 0; m < 4; ++m) { bf16_t* rowp = base + (size_t)(row0 + ai * HALF + m * 16) * ldc + col0;
                    f32x4 a0 = acc[ai][0][m][0], a1 = acc[ai][0][m][1], b0 = acc[ai][1][m][0], b1 = acc[ai][1][m][1];
                    if (glu) { b0 = sigm4(b0); b1 = sigm4(b1); }
                    *(u32x4*)rowp = pack8(a0 * b0, a1 * b1); }
        }
    }
};
struct EpiGateA {
    static constexpr bool PERM = true, AFTER_DRAIN = false;
    const bf16_t* SG; float* T; int ldc;
    __device__ __forceinline__ void operator()(const f32x4 (&acc)[2][2][4][2], const Unit& u, int wr, int wc, int fr, int fq) const {
        const int row0 = u.pm * BM + wr * 64 + fr, col0 = u.pn * BM + wc * 32 + 8 * fq;
#pragma unroll
        for (int ai = 0; ai < 2; ++ai)
#pragma unroll
            for (int m = 0; m < 4; ++m) { const size_t off = (size_t)(row0 + ai * HALF + m * 16) * ldc + col0;
#pragma unroll
                for (int bj = 0; bj < 2; ++bj) { f32x4 g0, g1; unpack8(*(const u32x4*)(SG + off + bj * HALF), g0, g1);
                    *(f32x4*)(T + off + bj * HALF) = g0 * acc[ai][bj][m][0]; *(f32x4*)(T + off + bj * HALF + 4) = g1 * acc[ai][bj][m][1]; } }
    }
};
struct EpiGateB {
    static constexpr bool PERM = true, AFTER_DRAIN = false;
    const bf16_t* SG; const float* T; bf16_t* O; int ldc;
    __device__ __forceinline__ void operator()(const f32x4 (&acc)[2][2][4][2], const Unit& u, int wr, int wc, int fr, int fq) const {
        const int row0 = u.pm * BM + wr * 64 + fr, col0 = u.pn * BM + wc * 32 + 8 * fq;
#pragma unroll
        for (int ai = 0; ai < 2; ++ai)
#pragma unroll
            for (int m = 0; m < 4; ++m) { const size_t off = (size_t)(row0 + ai * HALF + m * 16) * ldc + col0;
#pragma unroll
                for (int bj = 0; bj < 2; ++bj) { f32x4 g0, g1; unpack8(*(const u32x4*)(SG + off + bj * HALF), g0, g1);
                    const f32x4 t0 = *(const f32x4*)(T + off + bj * HALF), t1 = *(const f32x4*)(T + off + bj * HALF + 4);
                    *(u32x4*)(O + off + bj * HALF) = pack8(t0 + g0 * acc[ai][bj][m][0], t1 + g1 * acc[ai][bj][m][1]); } }
    }
};
struct EpiRes {
    static constexpr bool PERM = false, AFTER_DRAIN = false;
    const float* base; float* out; int ldc; float alpha;
    __device__ __forceinline__ void operator()(const f32x4 (&acc)[2][2][4][2], const Unit& u, int wr, int wc, int fr, int fq) const {
        const int row0 = u.pm * BM + wr * 64 + fr, col0 = u.pn * BM + wc * 32 + 4 * fq;
#pragma unroll
        for (int ai = 0; ai < 2; ++ai)
#pragma unroll
            for (int m = 0; m < 4; ++m) { const size_t off = (size_t)(row0 + ai * HALF + m * 16) * ldc + col0;
#pragma unroll
                for (int bj = 0; bj < 2; ++bj)
#pragma unroll
                    for (int n = 0; n < 2; ++n) { const f32x4 b = *(const f32x4*)(base + off + bj * HALF + n * 16);
                        *(f32x4*)(out + off + bj * HALF + n * 16) = b * alpha + acc[ai][bj][m][n]; } }
    }
};
struct EpiRelu2 {
    static constexpr bool PERM = true, AFTER_DRAIN = false;
    bf16_t* O; int ldc;
    __device__ __forceinline__ void operator()(const f32x4 (&acc)[2][2][4][2], const Unit& u, int wr, int wc, int fr, int fq) const {
        const int row0 = u.pm * BM + wr * 64 + fr, col0 = u.pn * BM + wc * 32 + 8 * fq;
#pragma unroll
        for (int ai = 0; ai < 2; ++ai)
#pragma unroll
            for (int m = 0; m < 4; ++m) { bf16_t* rowp = O + (size_t)(row0 + ai * HALF + m * 16) * ldc + col0;
#pragma unroll
                for (int bj = 0; bj < 2; ++bj) { f32x4 v0 = acc[ai][bj][m][0], v1 = acc[ai][bj][m][1];
                    v0 = __builtin_elementwise_max(v0, (f32x4){0.f, 0.f, 0.f, 0.f}); v1 = __builtin_elementwise_max(v1, (f32x4){0.f, 0.f, 0.f, 0.f});
                    *(u32x4*)(rowp + bj * HALF) = pack8(v0 * v0, v1 * v1); } }
    }
};

template <class Epi, class Sched, bool ALIGN_EPI>
__device__ __forceinline__ void gemm_phase(PG8_LAS unsigned char* lds, const Gemm g, const Sched& S, const Epi& E) {
    const int tid = threadIdx.x, wid = __builtin_amdgcn_readfirstlane(tid >> 6), lane = tid & 63, wr = wid >> 2, wc = wid & 3, fr = lane & 15, fq = lane >> 4;
    const int K = g.K, nt = K / BK;
    unsigned voffA[2], voffB[2];
#pragma unroll
    for (int i = 0; i < 2; ++i) { int R, C; stage_rc(tid * 16 + i * 8192, R, C); const int Rb = Epi::PERM ? ((R & ~31) + perm32(R & 31)) : R;
        voffA[i] = (unsigned)(R * g.lda + C) * 2u; voffB[i] = (unsigned)(Rb * g.ldb + C) * 2u; }
    const size_t kstep = (size_t)(BK * 2);
    const size_t hstepA = (size_t)HALF * g.lda * 2, hstepB = (size_t)HALF * g.ldb * 2;
    const size_t tstepA = 2 * hstepA, tstepB = 2 * hstepB;
    const unsigned ldsw = (unsigned)wid * 1024u;
    const int aoff = lds_byte(wr * 64 + fr, fq * 8), boff = lds_byte(wc * 32 + fr, fq * 8);
#define PG8_SA(b, h) (((b) * 2 + (h)) * HTB)
#define PG8_SB(b, h) ((4 + (b) * 2 + (h)) * HTB)
#define PG8_STAGE(bufoff, gbase, voff) do { _Pragma("unroll") for (int _i = 0; _i < 2; ++_i) \
        __builtin_amdgcn_global_load_lds((const unsigned*)((const char*)(gbase) + (voff)[_i]), (PG8_LAS unsigned*)(lds + (bufoff) + ldsw + _i * 8192), 16, 0, 0); } while (0)
#define PG8_LDA(dst, b, h) do { _Pragma("unroll") for (int m = 0; m < 4; ++m) _Pragma("unroll") for (int k = 0; k < 2; ++k) dst[m][k] = *(const PG8_LAS bf16x8*)(lds + PG8_SA(b, h) + aoff + m * 2048 + k * 1024); } while (0)
#define PG8_LDB(dst, b, h) do { _Pragma("unroll") for (int n = 0; n < 2; ++n) _Pragma("unroll") for (int k = 0; k < 2; ++k) dst[n][k] = *(const PG8_LAS bf16x8*)(lds + PG8_SB(b, h) + boff + n * 2048 + k * 1024); } while (0)
#define PG8_MMA(ai, bj, At, Bt) do { __builtin_amdgcn_s_setprio(1); _Pragma("unroll") for (int m = 0; m < 4; ++m) _Pragma("unroll") for (int n = 0; n < 2; ++n) _Pragma("unroll") for (int k = 0; k < 2; ++k) \
        acc[ai][bj][m][n] = __builtin_amdgcn_mfma_f32_16x16x32_bf16(Bt[n][k], At[m][k], acc[ai][bj][m][n], 0, 0, 0); __builtin_amdgcn_s_setprio(0); } while (0)
#define PG8_WAIT_V(n) asm volatile("s_waitcnt vmcnt(" #n ")" ::: "memory")
#define PG8_WAIT_L(n) asm volatile("s_waitcnt lgkmcnt(" #n ")" ::: "memory")
#define PG8_BAR __builtin_amdgcn_s_barrier()
#define PG8_SCHED __builtin_amdgcn_sched_barrier(0)
    Unit cur, nxt; int ui = 0;
    if (!S.next(0, cur)) return;
    f32x4 acc[2][2][4][2];
#pragma unroll
    for (int a = 0; a < 2; ++a)
#pragma unroll
        for (int b = 0; b < 2; ++b)
#pragma unroll
            for (int m = 0; m < 4; ++m)
#pragma unroll
                for (int n = 0; n < 2; ++n) acc[a][b][m][n] = (f32x4){0.f, 0.f, 0.f, 0.f};
    bf16x8 At[4][2], B0[2][2], B1[2][2];
    const char* cA = (const char*)g.A + (size_t)cur.pm * tstepA; const char* cB = (const char*)g.Bt + (size_t)cur.pn * tstepB;
    PG8_STAGE(PG8_SB(0, 0), cB, voffB); PG8_STAGE(PG8_SB(0, 1), cB + hstepB, voffB); PG8_STAGE(PG8_SA(0, 0), cA, voffA); PG8_STAGE(PG8_SA(0, 1), cA + hstepA, voffA);
    if (wr == 1) PG8_BAR;
    PG8_WAIT_V(2); PG8_BAR;
    PG8_STAGE(PG8_SB(1, 0), cB + kstep, voffB); PG8_STAGE(PG8_SA(1, 0), cA + kstep, voffA); PG8_STAGE(PG8_SB(1, 1), cB + hstepB + kstep, voffB);
    PG8_WAIT_V(6); PG8_BAR;
    for (;;) {
        const bool has_next = S.next(ui + 1, nxt);
        const char* nA = has_next ? (const char*)g.A + (size_t)nxt.pm * tstepA : cA; const char* nB = has_next ? (const char*)g.Bt + (size_t)nxt.pn * tstepB : cB;
        for (int t = 0; t < nt; t += 2) {
            const bool last = (t == nt - 2);
            const char* a1 = cA + (size_t)(t + 1) * kstep;
            const char* a2 = last ? nA : cA + (size_t)(t + 2) * kstep; const char* b2 = last ? nB : cB + (size_t)(t + 2) * kstep;
            const char* a3 = a2 + kstep; const char* b3 = b2 + kstep;
            PG8_LDB(B0, 0, 0); PG8_LDB(B1, 0, 1); PG8_SCHED; PG8_LDA(At, 0, 0); PG8_STAGE(PG8_SA(1, 1), a1 + hstepA, voffA);
            PG8_WAIT_V(8); PG8_WAIT_L(0); PG8_BAR; PG8_MMA(0, 0, At, B0); PG8_MMA(0, 1, At, B1); PG8_BAR; PG8_SCHED;
            PG8_LDA(At, 0, 1); PG8_STAGE(PG8_SB(0, 0), b2, voffB); PG8_STAGE(PG8_SB(0, 1), b2 + hstepB, voffB); PG8_STAGE(PG8_SA(0, 0), a2, voffA);
            PG8_WAIT_V(8); PG8_WAIT_L(0); PG8_BAR; PG8_MMA(1, 0, At, B0); PG8_MMA(1, 1, At, B1); PG8_BAR; PG8_SCHED;
            PG8_LDB(B0, 1, 0); PG8_LDB(B1, 1, 1); PG8_SCHED; PG8_LDA(At, 1, 0); PG8_STAGE(PG8_SA(0, 1), a2 + hstepA, voffA);
            PG8_WAIT_V(8); PG8_WAIT_L(0); PG8_BAR; PG8_MMA(0, 0, At, B0); PG8_MMA(0, 1, At, B1); PG8_BAR; PG8_SCHED;
            PG8_LDA(At, 1, 1); PG8_STAGE(PG8_SB(1, 0), b3, voffB); PG8_STAGE(PG8_SB(1, 1), b3 + hstepB, voffB); PG8_STAGE(PG8_SA(1, 0), a3, voffA);
            PG8_WAIT_V(8); PG8_WAIT_L(0); PG8_BAR; PG8_MMA(1, 0, At, B0); PG8_MMA(1, 1, At, B1); PG8_BAR; PG8_SCHED;
        }
        if constexpr (ALIGN_EPI) { if (wr == 0) PG8_BAR; }
        E(acc, cur, wr, wc, fr, fq);
        if (!has_next) break;
#pragma unroll
        for (int a = 0; a < 2; ++a)
#pragma unroll
            for (int b = 0; b < 2; ++b)
#pragma unroll
                for (int m = 0; m < 4; ++m)
#pragma unroll
                    for (int n = 0; n < 2; ++n) acc[a][b][m][n] = (f32x4){0.f, 0.f, 0.f, 0.f};
        cur = nxt; cA = nA; cB = nB; ++ui;
        if constexpr (ALIGN_EPI) { if (wr == 1) PG8_BAR; }
    }
    PG8_WAIT_V(0);
    if constexpr (!ALIGN_EPI) { if (wr == 0) PG8_BAR; }
    PG8_BAR;
#undef PG8_SA
#undef PG8_SB
#undef PG8_STAGE
#undef PG8_LDA
#undef PG8_LDB
#undef PG8_MMA
#undef PG8_WAIT_V
#undef PG8_WAIT_L
#undef PG8_BAR
#undef PG8_SCHED
}
}

constexpr int NWAVES = 8;
constexpr int BATCH = 4, SEQ = 8192, D = 1024, FF = 4096, NIN = 7 * D;
constexpr int M = BATCH * SEQ;
constexpr float LN_EPS = 1e-5f;
constexpr float ALPHA = 1.189207115002721f;
constexpr int TT = 32;
constexpr size_t MiB = 1u << 20;
constexpr size_t WS_WIN = 1 * MiB, WS_WAB = 15 * MiB, WS_WO = 19 * MiB, WS_WUP = 21 * MiB, WS_WDN = 29 * MiB;
constexpr size_t WS_XB = 40 * MiB;
constexpr size_t WS_BA = 104 * MiB, WS_CV = 168 * MiB, WS_U0 = 232 * MiB, WS_SGA = 296 * MiB, WS_SGB = 360 * MiB;
constexpr size_t WS_T = 104 * MiB;
constexpr size_t WS_MG = 40 * MiB;
constexpr size_t WS_X1B = 104 * MiB;
constexpr size_t WS_H = 168 * MiB;
constexpr size_t WS_END = 424 * MiB;
constexpr int LDS_BYTES = 147456;

#define GAS __attribute__((address_space(1)))
#define LAS __attribute__((address_space(3)))
typedef unsigned short bf16;
typedef unsigned v4u __attribute__((ext_vector_type(4)));
typedef unsigned v2u __attribute__((ext_vector_type(2)));
typedef float f32x4 __attribute__((ext_vector_type(4)));
typedef float f32x2 __attribute__((ext_vector_type(2)));
#define LDS_WAIT() asm volatile("s_waitcnt lgkmcnt(0)" ::: "memory")
__device__ __forceinline__ unsigned f2bf(float f) { unsigned u = __builtin_bit_cast(unsigned, f); return (u + 0x7fffu + ((u >> 16) & 1u)) >> 16; }
__device__ __forceinline__ unsigned pk2(float lo, float hi) { return f2bf(lo) | (f2bf(hi) << 16); }

struct Frame {
    LAS unsigned char* lds;
    int tid, lane, wave, vcu, G;
    const float *x, *w_in, *conv_a_w, *w_out_a, *conv_b_w, *conv_b_bias, *lnb_g, *lnb_b, *w_out_b, *w_o, *ln1_g, *ln1_b, *w_up, *w_down, *ln2_g, *ln2_b;
    float* out;
    bf16 *WIN, *WAB, *WO, *WUP, *WDN, *XB, *BA, *CV, *U0, *SGA, *SGB, *MG, *X1B, *HB;
    float* T;
};

__device__ __forceinline__ float wave_sum(float v) {
#pragma unroll
    for (int o = 1; o < 64; o <<= 1) v += __shfl_xor(v, o);
    return v;
}
__device__ __forceinline__ void p0_transpose_item(const float* W, int N, bf16* WT, int ldt, int koff, int k0, int n0, int drow0, LAS float* scr, int lane) {
#pragma unroll 8
    for (int i = 0; i < 32; ++i) { const int kk = 2 * i + (lane >> 5); scr[kk * 33 + (lane & 31)] = W[(size_t)(k0 + kk) * N + n0 + (lane & 31)]; }
    LDS_WAIT(); asm volatile("" ::: "memory");
    const int c = lane & 7;
#pragma unroll
    for (int j = 0; j < 4; ++j) { const int n = (lane >> 3) + 8 * j; const LAS float* s = scr + (8 * c) * 33 + n;
        v4u o; o.x = pk2(s[0 * 33], s[1 * 33]); o.y = pk2(s[2 * 33], s[3 * 33]); o.z = pk2(s[4 * 33], s[5 * 33]); o.w = pk2(s[6 * 33], s[7 * 33]);
        *(GAS v4u*)(WT + (size_t)(drow0 + n) * ldt + koff + k0 + 8 * c) = o; }
    LDS_WAIT(); asm volatile("" ::: "memory");
}
__device__ __forceinline__ int win_row(int n0) {
    const int seg = n0 >> 10, j = n0 & 1023;
    if (seg == 0) return j;
    if (seg == 1) return 1024 + (j >> 7) * 256 + (j & 127);
    if (seg == 2) return 1024 + (j >> 7) * 256 + 128 + (j & 127);
    if (seg == 3) return 3072 + (j >> 7) * 256 + (j & 127);
    if (seg == 4) return 3072 + (j >> 7) * 256 + 128 + (j & 127);
    if (seg == 5) return 5120 + j;
    return 6144 + j;
}
__device__ __forceinline__ void p0_prologue(Frame& F) {
    LAS float* scr = (LAS float*)(F.lds + F.wave * 16384);
    const int gw = F.vcu * NWAVES + F.wave, NGW = F.G * NWAVES;
    constexpr int I_IN = (D / 64) * (NIN / 32), I_SQ = (D / 64) * (D / 32), I_UP = (D / 64) * (FF / 32), I_DN = (FF / 64) * (D / 32);
    constexpr int NITEMS = I_IN + 3 * I_SQ + I_UP + I_DN;
    for (int it = gw; it < NITEMS; it += NGW) {
        int r = it;
        if (r < I_IN) { const int nb = NIN / 32, k0 = 64 * (r / nb), n0 = 32 * (r % nb); p0_transpose_item(F.w_in, NIN, F.WIN, D, 0, k0, n0, win_row(n0), scr, F.lane); continue; } r -= I_IN;
        if (r < I_SQ) { const int nb = D / 32, k0 = 64 * (r / nb), n0 = 32 * (r % nb); p0_transpose_item(F.w_out_a, D, F.WAB, 2 * D, 0, k0, n0, n0, scr, F.lane); continue; } r -= I_SQ;
        if (r < I_SQ) { const int nb = D / 32, k0 = 64 * (r / nb), n0 = 32 * (r % nb); p0_transpose_item(F.w_out_b, D, F.WAB, 2 * D, D, k0, n0, n0, scr, F.lane); continue; } r -= I_SQ;
        if (r < I_SQ) { const int nb = D / 32, k0 = 64 * (r / nb), n0 = 32 * (r % nb); p0_transpose_item(F.w_o, D, F.WO, D, 0, k0, n0, n0, scr, F.lane); continue; } r -= I_SQ;
        if (r < I_UP) { const int nb = FF / 32, k0 = 64 * (r / nb), n0 = 32 * (r % nb); p0_transpose_item(F.w_up, FF, F.WUP, D, 0, k0, n0, n0, scr, F.lane); continue; } r -= I_UP;
        { const int nb = D / 32, k0 = 64 * (r / nb), n0 = 32 * (r % nb); p0_transpose_item(F.w_down, D, F.WDN, FF, 0, k0, n0, n0, scr, F.lane); }
    }
    const size_t ngrp = (size_t)M * D / 8, nthr = (size_t)F.G * NWAVES * 64;
    for (size_t i = (size_t)blockIdx.x * (NWAVES * 64) + F.tid; i < ngrp; i += nthr) {
        const f32x4 a = *(const GAS f32x4*)(F.x + i * 8), b = *(const GAS f32x4*)(F.x + i * 8 + 4);
        v4u o; o.x = pk2(a[0], a[1]); o.y = pk2(a[2], a[3]); o.z = pk2(b[0], b[1]); o.w = pk2(b[2], b[3]);
        *(GAS v4u*)(F.XB + i * 8) = o;
    }
}


template <int R> struct ConvRows {
    static __device__ __forceinline__ void run(f32x2 (&acc)[TT], const f32x2 (&wb)[31], const GAS unsigned* up, bool first) {
        unsigned raw = 0u;
        if (R >= 30 || !first) raw = up[(ptrdiff_t)(R - 30) * (D / 2)];
        const f32x2 xv = (f32x2){__uint_as_float(raw << 16), __uint_as_float(raw & 0xffff0000u)};
        constexpr int TLO = R > 30 ? R - 30 : 0, THI = R < TT - 1 ? R : TT - 1;
#pragma unroll
        for (int t = TLO; t <= THI; ++t) acc[t] = acc[t] + wb[R - t] * xv;
        ConvRows<R + 1>::run(acc, wb, up, first);
    }
};
template <> struct ConvRows<TT + 30> { static __device__ __forceinline__ void run(f32x2 (&)[TT], const f32x2 (&)[31], const GAS unsigned*, bool) {} };

__device__ __forceinline__ void p2_mixers(Frame& F, bf16* YU) {
    const int tid = F.tid;
    f32x2 wb[31];
#pragma unroll
    for (int k = 0; k < 31; ++k) wb[k] = *(const GAS f32x2*)(F.conv_b_w + k * D + 2 * tid);
    const f32x2 bias = *(const GAS f32x2*)(F.conv_b_bias + 2 * tid), gam = *(const GAS f32x2*)(F.lnb_g + 2 * tid), bet = *(const GAS f32x2*)(F.lnb_b + 2 * tid);
    const f32x2 wa0 = *(const GAS f32x2*)(F.conv_a_w + 2 * tid), wa1 = *(const GAS f32x2*)(F.conv_a_w + D + 2 * tid), wa2 = *(const GAS f32x2*)(F.conv_a_w + 2 * D + 2 * tid);
    LAS float* red = (LAS float*)F.lds;
    LAS float* stats = red + 2 * TT * 520;
    for (int ch = blockIdx.x; ch < M / TT; ch += F.G) {
        const int t0 = ch * TT; const bool first = (t0 % SEQ) == 0;
        f32x2 acc[TT];
#pragma unroll
        for (int t = 0; t < TT; ++t) acc[t] = bias;
        const GAS unsigned* up = (const GAS unsigned*)F.U0 + ((size_t)t0 * (D / 2) + tid);
        ConvRows<0>::run(acc, wb, up, first);
#pragma unroll
        for (int t = 0; t < TT; ++t) { red[(2 * t) * 520 + tid] = acc[t].x + acc[t].y; red[(2 * t + 1) * 520 + tid] = acc[t].x * acc[t].x + acc[t].y * acc[t].y; }
        __syncthreads();
        {
            const int v = tid >> 3, seg = tid & 7; float a = 0.f;
#pragma unroll 16
            for (int i = 0; i < 64; ++i) a += red[v * 520 + seg + 8 * i];
            a += __shfl_xor(a, 1); a += __shfl_xor(a, 2); a += __shfl_xor(a, 4);
            const float other = __shfl_xor(a, 8);
            if ((tid & 15) == 0) { const float mean = a * (1.f / D); const float var = fmaxf(other * (1.f / D) - mean * mean, 0.f); stats[v] = mean; stats[v + 1] = 1.0f / sqrtf(var + LN_EPS); }
        }
        __syncthreads();
        GAS unsigned* yb = (GAS unsigned*)YU + ((size_t)t0 * D + D / 2 + tid);
#pragma unroll
        for (int t = 0; t < TT; ++t) { const float mean = stats[2 * t], rstd = stats[2 * t + 1];
            f32x2 y = (acc[t] - mean) * rstd * gam + bet;
            y.x = y.x * pg8::sigm(y.x); y.y = y.y * pg8::sigm(y.y);
            yb[(size_t)t * D] = pk2(y.x, y.y); }
        const GAS unsigned* cp = (const GAS unsigned*)F.CV + ((size_t)t0 * (D / 2) + tid);
        const GAS unsigned* bp = (const GAS unsigned*)F.BA + ((size_t)t0 * (D / 2) + tid);
        GAS unsigned* ya = (GAS unsigned*)YU + ((size_t)t0 * D + tid);
        unsigned r2 = 0u, r1 = 0u;
        if (!first) { r2 = cp[-(ptrdiff_t)(2 * (D / 2))]; r1 = cp[-(ptrdiff_t)(D / 2)]; }
        f32x2 c2 = (f32x2){__uint_as_float(r2 << 16), __uint_as_float(r2 & 0xffff0000u)}, c1 = (f32x2){__uint_as_float(r1 << 16), __uint_as_float(r1 & 0xffff0000u)};
#pragma unroll 8
        for (int t = 0; t < TT; ++t) { const unsigned rc = cp[(size_t)t * (D / 2)], rb = bp[(size_t)t * (D / 2)];
            const f32x2 c0 = (f32x2){__uint_as_float(rc << 16), __uint_as_float(rc & 0xffff0000u)}, b = (f32x2){__uint_as_float(rb << 16), __uint_as_float(rb & 0xffff0000u)};
            const f32x2 y = b * (wa0 * c2 + wa1 * c1 + wa2 * c0);
            ya[(size_t)t * D] = pk2(y.x, y.y); c2 = c1; c1 = c0; }
    }
}

__device__ __forceinline__ void ln_rows(Frame& F, const float* src, const float* gamma, const float* beta, float* dstf, bf16* dstb) {
    const int gw = F.vcu * NWAVES + F.wave, NGW = F.G * NWAVES;
    f32x4 g[4], b[4];
#pragma unroll
    for (int j = 0; j < 4; ++j) { g[j] = *((const GAS f32x4*)gamma + F.lane + 64 * j); b[j] = *((const GAS f32x4*)beta + F.lane + 64 * j); }
    for (int m = gw; m < M; m += NGW) {
        const GAS f32x4* xr = (const GAS f32x4*)(src + (size_t)m * D) + F.lane;
        f32x4 v[4]; float s = 0.f;
#pragma unroll
        for (int j = 0; j < 4; ++j) { v[j] = xr[64 * j]; s += (v[j].x + v[j].y) + (v[j].z + v[j].w); }
        const float mean = wave_sum(s) * (1.f / D); float s2 = 0.f;
#pragma unroll
        for (int j = 0; j < 4; ++j) { v[j] = v[j] - mean; s2 += (v[j].x * v[j].x + v[j].y * v[j].y) + (v[j].z * v[j].z + v[j].w * v[j].w); }
        const float rstd = 1.f / sqrtf(wave_sum(s2) * (1.f / D) + LN_EPS);
        GAS f32x4* of = (GAS f32x4*)(dstf + (size_t)m * D) + F.lane;
#pragma unroll
        for (int j = 0; j < 4; ++j) { v[j] = v[j] * rstd * g[j] + b[j]; of[64 * j] = v[j]; }
        if (dstb) { GAS v2u* ob = (GAS v2u*)(dstb + (size_t)m * D) + F.lane;
#pragma unroll
            for (int j = 0; j < 4; ++j) { v2u w; w.x = pk2(v[j].x, v[j].y); w.y = pk2(v[j].z, v[j].w); ob[64 * j] = w; } }
    }
}

struct Args { const float* in[16]; float* out; unsigned char* ws; };

__global__ void __launch_bounds__(NWAVES * 64, 2) mega_fwd(Args args) {
    extern __shared__ __attribute__((aligned(16))) unsigned char lds[];
    cg::grid_group grid = cg::this_grid();
    Frame F;
    F.lds = (LAS unsigned char*)lds;
    F.tid = threadIdx.x; F.lane = F.tid & 63; F.wave = __builtin_amdgcn_readfirstlane(F.tid >> 6);
    F.G = gridDim.x; { const int bx = blockIdx.x; F.vcu = (F.G % 8 == 0) ? (bx % 8) * (F.G / 8) + bx / 8 : bx; }
    unsigned char* ws = args.ws;
    F.x = args.in[0]; F.w_in = args.in[1]; F.conv_a_w = args.in[2]; F.w_out_a = args.in[3]; F.conv_b_w = args.in[4]; F.conv_b_bias = args.in[5];
    F.lnb_g = args.in[6]; F.lnb_b = args.in[7]; F.w_out_b = args.in[8]; F.w_o = args.in[9]; F.ln1_g = args.in[10]; F.ln1_b = args.in[11];
    F.w_up = args.in[12]; F.w_down = args.in[13]; F.ln2_g = args.in[14]; F.ln2_b = args.in[15]; F.out = args.out;
    F.WIN = (bf16*)(ws + WS_WIN); F.WAB = (bf16*)(ws + WS_WAB); F.WO = (bf16*)(ws + WS_WO); F.WUP = (bf16*)(ws + WS_WUP); F.WDN = (bf16*)(ws + WS_WDN);
    F.XB = (bf16*)(ws + WS_XB); F.BA = (bf16*)(ws + WS_BA); F.CV = (bf16*)(ws + WS_CV); F.U0 = (bf16*)(ws + WS_U0); F.SGA = (bf16*)(ws + WS_SGA); F.SGB = (bf16*)(ws + WS_SGB);
    F.MG = (bf16*)(ws + WS_MG); F.X1B = (bf16*)(ws + WS_X1B); F.HB = (bf16*)(ws + WS_H); F.T = (float*)(ws + WS_T);
    bf16* YU = (bf16*)F.out;

    p0_prologue(F);
    grid.sync();
    { pg8::Gemm g{F.XB, F.WIN, M, NIN, D, D, D}; pg8::StaticOrder S; S.init(M, NIN, F.G, (int)blockIdx.x);
      pg8::EpiP1 E{F.BA, (size_t)(WS_CV - WS_BA) / 2, D};
      static_assert(WS_CV - WS_BA == WS_U0 - WS_CV && WS_U0 - WS_CV == WS_SGA - WS_U0 && WS_SGA - WS_U0 == WS_SGB - WS_SGA, "P1 outputs equally spaced");
      pg8::gemm_phase<pg8::EpiP1, pg8::StaticOrder, true>(F.lds, g, S, E); }
    grid.sync();
    p2_mixers(F, YU);
    grid.sync();
    { pg8::Gemm g{YU, F.WAB, M, D, D, 2 * D, 2 * D}; pg8::StaticOrder S; S.init(M, D, F.G, (int)blockIdx.x);
      pg8::EpiGateA E{F.SGA, F.T, D};
      pg8::gemm_phase<pg8::EpiGateA, pg8::StaticOrder, true>(F.lds, g, S, E); }
    grid.sync();
    { pg8::Gemm g{YU + D, F.WAB + D, M, D, D, 2 * D, 2 * D}; pg8::StaticOrder S; S.init(M, D, F.G, (int)blockIdx.x);
      pg8::EpiGateB E{F.SGB, F.T, F.MG, D};
      pg8::gemm_phase<pg8::EpiGateB, pg8::StaticOrder, true>(F.lds, g, S, E); }
    grid.sync();
    { pg8::Gemm g{F.MG, F.WO, M, D, D, D, D}; pg8::StaticOrder S; S.init(M, D, F.G, (int)blockIdx.x);
      pg8::EpiRes E{F.x, F.out, D, ALPHA};
      pg8::gemm_phase<pg8::EpiRes, pg8::StaticOrder, true>(F.lds, g, S, E); }
    grid.sync();
    ln_rows(F, F.out, F.ln1_g, F.ln1_b, F.out, F.X1B);
    grid.sync();
    { pg8::Gemm g{F.X1B, F.WUP, M, FF, D, D, D}; pg8::StaticOrder S; S.init(M, FF, F.G, (int)blockIdx.x);
      pg8::EpiRelu2 E{F.HB, FF};
      pg8::gemm_phase<pg8::EpiRelu2, pg8::StaticOrder, true>(F.lds, g, S, E); }
    grid.sync();
    { pg8::Gemm g{F.HB, F.WDN, M, D, FF, FF, FF}; pg8::StaticOrder S; S.init(M, D, F.G, (int)blockIdx.x);
      pg8::EpiRes E{F.out, F.out, D, ALPHA};
      pg8::gemm_phase<pg8::EpiRes, pg8::StaticOrder, true>(F.lds, g, S, E); }
    grid.sync();
    ln_rows(F, F.out, F.ln2_g, F.ln2_b, F.out, nullptr);
}

extern "C" void kernel_launch(void* const* d_in, const int* in_sizes, int n_in, void* d_out, int out_size, void* d_ws, size_t ws_size, hipStream_t stream) {
    static int grid = 0;
    if (grid == 0) {
        if (n_in != 16 || in_sizes[0] != M * D || out_size != M * D || ws_size < WS_END) { fprintf(stderr, "kernel_launch: unexpected shapes (n_in %d, in0 %d, out %d, ws %zu)\n", n_in, n_in > 0 ? in_sizes[0] : -1, out_size, ws_size); grid = -1; return; }
        int dev = 0, cus = 0, per_cu = 0;
        if (hipGetDevice(&dev) != hipSuccess || hipDeviceGetAttribute(&cus, hipDeviceAttributeMultiprocessorCount, dev) != hipSuccess) { grid = -1; return; }
        if (hipFuncSetAttribute((const void*)mega_fwd, hipFuncAttributeMaxDynamicSharedMemorySize, LDS_BYTES) != hipSuccess) { fprintf(stderr, "kernel_launch: hipFuncSetAttribute failed\n"); grid = -1; return; }
        if (hipOccupancyMaxActiveBlocksPerMultiprocessor(&per_cu, (const void*)mega_fwd, NWAVES * 64, LDS_BYTES) != hipSuccess || per_cu < 1) { fprintf(stderr, "kernel_launch: occupancy query failed (%d)\n", per_cu); (void)hipGetLastError(); per_cu = 1; }
        grid = cus * (per_cu > 1 ? 1 : per_cu);
    }
    if (grid < 0) return;
    Args a{};
    for (int i = 0; i < 16; ++i) a.in[i] = (const float*)d_in[i];
    a.out = (float*)d_out; a.ws = (unsigned char*)d_ws;
    void* kargs[] = {&a};
    hipError_t e = hipLaunchCooperativeKernel((const void*)mega_fwd, dim3(grid), dim3(NWAVES * 64), kargs, LDS_BYTES, stream);
    if (e != hipSuccess) fprintf(stderr, "kernel_launch: cooperative launch failed: %s (grid %d)\n", hipGetErrorString(e), grid);
}
```

```cpp
#include <hip/hip_runtime.h>
#include <hip/hip_cooperative_groups.h>
#include <cstdio>
#include <cstdint>
namespace cg = cooperative_groups;

namespace pg8 {
#define PG8_LAS __attribute__((address_space(3)))
typedef unsigned short bf16_t;
typedef short bf16x8 __attribute__((ext_vector_type(8)));
typedef float f32x4 __attribute__((ext_vector_type(4)));
typedef float f32x2 __attribute__((ext_vector_type(2)));
typedef unsigned u32x4 __attribute__((ext_vector_type(4)));
constexpr int BM = 256, BK = 64, HALF = 128, HTB = HALF * BK * 2, STAGE_BYTES = 8 * HTB, NXCD = 8, WGM = 8;

__host__ __device__ __forceinline__ int lds_byte(int r, int c) { const int st = (r >> 4) * 2 + (c >> 5), rr = r & 15, cc = c & 31, ob = rr * 64 + cc * 2; return st * 1024 + (ob ^ (((ob >> 9) & 1) << 5)); }
__host__ __device__ __forceinline__ void stage_rc(int b, int& R, int& C) { const int st = b / 1024, sb = b % 1024, swz = sb ^ (((sb >> 9) & 1) << 5); R = (st >> 1) * 16 + swz / 64; C = (st & 1) * 32 + (swz % 64) / 2; }
__host__ __device__ __forceinline__ int perm32(int rho) { const int n = rho >> 4, i = rho & 15; return 8 * (i >> 2) + 4 * n + (i & 3); }

struct Unit { int pm, pn; };
struct Gemm { const bf16_t* A; const bf16_t* Bt; int M, N, K, lda, ldb; };

struct StaticOrder {
    int nM, nN, nwg, G, c;
    __host__ __device__ void init(int M, int N, int G_, int c_) { nM = M / BM; nN = N / BM; nwg = nM * nN; G = G_; c = c_; }
    __host__ __device__ bool next(int i, Unit& u) const {
        const long L = (long)i * G + c; if (L >= nwg) return false;
        int wgid = (int)L; { const int q = nwg / NXCD, r = nwg % NXCD, xcd = wgid % NXCD, off = wgid / NXCD; wgid = (xcd < r ? xcd * (q + 1) : r * (q + 1) + (xcd - r) * q) + off; }
        const int nig = WGM * nN, gid = wgid / nig, fm = gid * WGM, gsz = (nM - fm) < WGM ? (nM - fm) : WGM;
        u.pm = fm + ((wgid % nig) % gsz); u.pn = (wgid % nig) / gsz; return true;
    }
};

__device__ __forceinline__ unsigned cvt_pk_bf16(float lo, float hi) { unsigned r; asm volatile("v_cvt_pk_bf16_f32 %0, %1, %2" : "=v"(r) : "v"(lo), "v"(hi)); return r; }
__device__ __forceinline__ float sigm(float x) { return __builtin_amdgcn_rcpf(1.0f + __builtin_amdgcn_exp2f(-1.4426950408889634f * x)); }
__device__ __forceinline__ f32x4 sigm4(f32x4 v) { return (f32x4){sigm(v[0]), sigm(v[1]), sigm(v[2]), sigm(v[3])}; }
__device__ __forceinline__ u32x4 pack8(f32x4 v0, f32x4 v1) { u32x4 w; w.x = cvt_pk_bf16(v0[0], v0[1]); w.y = cvt_pk_bf16(v0[2], v0[3]); w.z = cvt_pk_bf16(v1[0], v1[1]); w.w = cvt_pk_bf16(v1[2], v1[3]); return w; }
__device__ __forceinline__ void unpack8(u32x4 w, f32x4& v0, f32x4& v1) {
    v0[0] = __uint_as_float(w.x << 16); v0[1] = __uint_as_float(w.x & 0xffff0000u); v0[2] = __uint_as_float(w.y << 16); v0[3] = __uint_as_float(w.y & 0xffff0000u);
    v1[0] = __uint_as_float(w.z << 16); v1[1] = __uint_as_float(w.z & 0xffff0000u); v1[2] = __uint_as_float(w.w << 16); v1[3] = __uint_as_float(w.w & 0xffff0000u);
}

struct EpiP1 {
    static constexpr bool PERM = true, AFTER_DRAIN = false;
    bf16_t* P5; size_t seg; int ldc;
    __device__ __forceinline__ void operator()(const f32x4 (&acc)[2][2][4][2], const Unit& u, int wr, int wc, int fr, int fq) const {
        const int row0 = u.pm * BM + wr * 64 + fr, pn = u.pn;
        if (pn < 4 || pn >= 20) {
            bf16_t* base = P5 + (pn < 4 ? (size_t)0 : (pn < 24 ? 3 * seg : 4 * seg)); const int colt = pn < 4 ? pn * 256 : (pn < 24 ? (pn - 20) * 256 : (pn - 24) * 256); const bool sg = pn >= 20;
            const int col0 = colt + wc * 32 + 8 * fq;
#pragma unroll
            for (int ai = 0; ai < 2; ++ai)
#pragma unroll
                for (int m = 0; m < 4; ++m) { bf16_t* rowp = base + (size_t)(row0 + ai * HALF + m * 16) * ldc + col0;
#pragma unroll
                    for (int bj = 0; bj < 2; ++bj) { f32x4 v0 = acc[ai][bj][m][0], v1 = acc[ai][bj][m][1];
                        if (sg) { v0 = sigm4(v0); v1 = sigm4(v1); }
                        *(u32x4*)(rowp + bj * HALF) = pack8(v0, v1); } }
        } else {
            const bool glu = pn >= 12; bf16_t* base = P5 + (glu ? 2 * seg : seg); const int t = glu ? pn - 12 : pn - 4; const int col0 = t * 128 + wc * 32 + 8 * fq;
#pragma unroll
            for (int ai = 0; ai < 2; ++ai)
#pragma unroll
                for (int m = 0; m < 4; ++m) { bf16_t* rowp = base + (size_t)(row0 + ai * HALF + m * 16) * ldc + col0;
                    f32x4 a0 = acc[ai][0][m][0], a1 = acc[ai][0][m][1], b0 = acc[ai][1][m][0], b1 = acc[ai][1][m][1];
                    if (glu) { b0 = sigm4(b0); b1 = sigm4(b1); }
                    *(u32x4*)rowp = pack8(a0 * b0, a1 * b1); }
        }
    }
};
struct EpiGateA {
    static constexpr bool PERM = true, AFTER_DRAIN = false;
    const bf16_t* SG; float* T; int ldc;
    __device__ __forceinline__ void operator()(const f32x4 (&acc)[2][2][4][2], const Unit& u, int wr, int wc, int fr, int fq) const {
        const int row0 = u.pm * BM + wr * 64 + fr, col0 = u.pn * BM + wc * 32 + 8 * fq;
#pragma unroll
        for (int ai = 0; ai < 2; ++ai)
#pragma unroll
            for (int m = 0; m < 4; ++m) { const size_t off = (size_t)(row0 + ai * HALF + m * 16) * ldc + col0;
#pragma unroll
                for (int bj = 0; bj < 2; ++bj) { f32x4 g0, g1; unpack8(*(const u32x4*)(SG + off + bj * HALF), g0, g1);
                    *(f32x4*)(T + off + bj * HALF) = g0 * acc[ai][bj][m][0]; *(f32x4*)(T + off + bj * HALF + 4) = g1 * acc[ai][bj][m][1]; } }
    }
};
struct EpiGateB {
    static constexpr bool PERM = true, AFTER_DRAIN = false;
    const bf16_t* SG; const float* T; bf16_t* O; int ldc;
    __device__ __forceinline__ void operator()(const f32x4 (&acc)[2][2][4][2], const Unit& u, int wr, int wc, int fr, int fq) const {
        const int row0 = u.pm * BM + wr * 64 + fr, col0 = u.pn * BM + wc * 32 + 8 * fq;
#pragma unroll
        for (int ai = 0; ai < 2; ++ai)
#pragma unroll
            for (int m = 0; m < 4; ++m) { const size_t off = (size_t)(row0 + ai * HALF + m * 16) * ldc + col0;
#pragma unroll
                for (int bj = 0; bj < 2; ++bj) { f32x4 g0, g1; unpack8(*(const u32x4*)(SG + off + bj * HALF), g0, g1);
                    const f32x4 t0 = *(const f32x4*)(T + off + bj * HALF), t1 = *(const f32x4*)(T + off + bj * HALF + 4);
                    *(u32x4*)(O + off + bj * HALF) = pack8(t0 + g0 * acc[ai][bj][m][0], t1 + g1 * acc[ai][bj][m][1]); } }
    }
};
struct EpiRes {
    static constexpr bool PERM = false, AFTER_DRAIN = false;
    const float* base; float* out; int ldc; float alpha;
    __device__ __forceinline__ void operator()(const f32x4 (&acc)[2][2][4][2], const Unit& u, int wr, int wc, int fr, int fq) const {
        const int row0 = u.pm * BM + wr * 64 + fr, col0 = u.pn * BM + wc * 32 + 4 * fq;
#pragma unroll
        for (int ai = 0; ai < 2; ++ai)
#pragma unroll
            for (int m = 0; m < 4; ++m) { const size_t off = (size_t)(row0 + ai * HALF + m * 16) * ldc + col0;
#pragma unroll
                for (int bj = 0; bj < 2; ++bj)
#pragma unroll
                    for (int n = 0; n < 2; ++n) { const f32x4 b = *(const f32x4*)(base + off + bj * HALF + n * 16);
                        *(f32x4*)(out + off + bj * HALF + n * 16) = b * alpha + acc[ai][bj][m][n]; } }
    }
};
struct EpiRelu2 {
    static constexpr bool PERM = true, AFTER_DRAIN = false;
    bf16_t* O; int ldc;
    __device__ __forceinline__ void operator()(const f32x4 (&acc)[2][2][4][2], const Unit& u, int wr, int wc, int fr, int fq) const {
        const int row0 = u.pm * BM + wr * 64 + fr, col0 = u.pn * BM + wc * 32 + 8 * fq;
#pragma unroll
        for (int ai = 0; ai < 2; ++ai)
#pragma unroll
            for (int m = 0; m < 4; ++m) { bf16_t* rowp = O + (size_t)(row0 + ai * HALF + m * 16) * ldc + col0;
#pragma unroll
                for (int bj = 0; bj < 2; ++bj) { f32x4 v0 = acc[ai][bj][m][0], v1 = acc[ai][bj][m][1];
                    v0 = __builtin_elementwise_max(v0, (f32x4){0.f, 0.f, 0.f, 0.f}); v1 = __builtin_elementwise_max(v1, (f32x4){0.f, 0.f, 0.f, 0.f});
                    *(u32x4*)(rowp + bj * HALF) = pack8(v0 * v0, v1 * v1); } }
    }
};

template <class Epi, class Sched, bool ALIGN_EPI>
__device__ __forceinline__ void gemm_phase(PG8_LAS unsigned char* lds, const Gemm g, const Sched& S, const Epi& E) {
    const int tid = threadIdx.x, wid = __builtin_amdgcn_readfirstlane(tid >> 6), lane = tid & 63, wr = wid >> 2, wc = wid & 3, fr = lane & 15, fq = lane >> 4;
    const int K = g.K, nt = K / BK;
    unsigned voffA[2], voffB[2];
#pragma unroll
    for (int i = 0; i < 2; ++i) { int R, C; stage_rc(tid * 16 + i * 8192, R, C); const int Rb = Epi::PERM ? ((R & ~31) + perm32(R & 31)) : R;
        voffA[i] = (unsigned)(R * g.lda + C) * 2u; voffB[i] = (unsigned)(Rb * g.ldb + C) * 2u; }
    const size_t kstep = (size_t)(BK * 2);
    const size_t hstepA = (size_t)HALF * g.lda * 2, hstepB = (size_t)HALF * g.ldb * 2;
    const size_t tstepA = 2 * hstepA, tstepB = 2 * hstepB;
    const unsigned ldsw = (unsigned)wid * 1024u;
    const int aoff = lds_byte(wr * 64 + fr, fq * 8), boff = lds_byte(wc * 32 + fr, fq * 8);
#define PG8_SA(b, h) (((b) * 2 + (h)) * HTB)
#define PG8_SB(b, h) ((4 + (b) * 2 + (h)) * HTB)
#define PG8_STAGE(bufoff, gbase, voff) do { _Pragma("unroll") for (int _i = 0; _i < 2; ++_i) \
        __builtin_amdgcn_global_load_lds((const unsigned*)((const char*)(gbase) + (voff)[_i]), (PG8_LAS unsigned*)(lds + (bufoff) + ldsw + _i * 8192), 16, 0, 0); } while (0)
#define PG8_LDA(dst, b, h) do { _Pragma("unroll") for (int m = 0; m < 4; ++m) _Pragma("unroll") for (int k = 0; k < 2; ++k) dst[m][k] = *(const PG8_LAS bf16x8*)(lds + PG8_SA(b, h) + aoff + m * 2048 + k * 1024); } while (0)
#define PG8_LDB(dst, b, h) do { _Pragma("unroll") for (int n = 0; n < 2; ++n) _Pragma("unroll") for (int k = 0; k < 2; ++k) dst[n][k] = *(const PG8_LAS bf16x8*)(lds + PG8_SB(b, h) + boff + n * 2048 + k * 1024); } while (0)
#define PG8_MMA(ai, bj, At, Bt) do { __builtin_amdgcn_s_setprio(1); _Pragma("unroll") for (int m = 0; m < 4; ++m) _Pragma("unroll") for (int n = 0; n < 2; ++n) _Pragma("unroll") for (int k = 0; k < 2; ++k) \
        acc[ai][bj][m][n] = __builtin_amdgcn_mfma_f32_16x16x32_bf16(Bt[n][k], At[m][k], acc[ai][bj][m][n], 0, 0, 0); __builtin_amdgcn_s_setprio(0); } while (0)
#define PG8_WAIT_V(n) asm volatile("s_waitcnt vmcnt(" #n ")" ::: "memory")
#define PG8_WAIT_L(n) asm volatile("s_waitcnt lgkmcnt(" #n ")" ::: "memory")
#define PG8_BAR __builtin_amdgcn_s_barrier()
#define PG8_SCHED __builtin_amdgcn_sched_barrier(0)
    Unit cur, nxt; int ui = 0;
    if (!S.next(0, cur)) return;
    f32x4 acc[2][2][4][2];
#pragma unroll
    for (int a = 0; a < 2; ++a)
#pragma unroll
        for (int b = 0; b < 2; ++b)
#pragma unroll
            for (int m = 0; m < 4; ++m)
#pragma unroll
                for (int n = 0; n < 2; ++n) acc[a][b][m][n] = (f32x4){0.f, 0.f, 0.f, 0.f};
    bf16x8 At[4][2], B0[2][2], B1[2][2];
    const char* cA = (const char*)g.A + (size_t)cur.pm * tstepA; const char* cB = (const char*)g.Bt + (size_t)cur.pn * tstepB;
    PG8_STAGE(PG8_SB(0, 0), cB, voffB); PG8_STAGE(PG8_SB(0, 1), cB + hstepB, voffB); PG8_STAGE(PG8_SA(0, 0), cA, voffA); PG8_STAGE(PG8_SA(0, 1), cA + hstepA, voffA);
    if (wr == 1) PG8_BAR;
    PG8_WAIT_V(2); PG8_BAR;
    PG8_STAGE(PG8_SB(1, 0), cB + kstep, voffB); PG8_STAGE(PG8_SA(1, 0), cA + kstep, voffA); PG8_STAGE(PG8_SB(1, 1), cB + hstepB + kstep, voffB);
    PG8_WAIT_V(6); PG8_BAR;
    for (;;) {
        const bool has_next = S.next(ui + 1, nxt);
        const char* nA = has_next ? (const char*)g.A + (size_t)nxt.pm * tstepA : cA; const char* nB = has_next ? (const char*)g.Bt + (size_t)nxt.pn * tstepB : cB;
        for (int t = 0; t < nt; t += 2) {
            const bool last = (t == nt - 2);
            const char* a1 = cA + (size_t)(t + 1) * kstep;
            const char* a2 = last ? nA : cA + (size_t)(t + 2) * kstep; const char* b2 = last ? nB : cB + (size_t)(t + 2) * kstep;
            const char* a3 = a2 + kstep; const char* b3 = b2 + kstep;
            PG8_LDB(B0, 0, 0); PG8_LDB(B1, 0, 1); PG8_SCHED; PG8_LDA(At, 0, 0); PG8_STAGE(PG8_SA(1, 1), a1 + hstepA, voffA);
            PG8_WAIT_V(8); PG8_WAIT_L(0); PG8_BAR; PG8_MMA(0, 0, At, B0); PG8_MMA(0, 1, At, B1); PG8_BAR; PG8_SCHED;
            PG8_LDA(At, 0, 1); PG8_STAGE(PG8_SB(0, 0), b2, voffB); PG8_STAGE(PG8_SB(0, 1), b2 + hstepB, voffB); PG8_STAGE(PG8_SA(0, 0), a2, voffA);
            PG8_WAIT_V(8); PG8_WAIT_L(0); PG8_BAR; PG8_MMA(1, 0, At, B0); PG8_MMA(1, 1, At, B1); PG8_BAR; PG8_SCHED;
            PG8_LDB(B0, 1, 0); PG8_LDB(B1, 1, 1); PG8_SCHED; PG8_LDA(At, 1, 0); PG8_STAGE(PG8_SA(0, 1), a2 + hstepA, voffA);
            PG8_WAIT_V(8); PG8_WAIT_L(0); PG8_BAR; PG8_MMA(0, 0, At, B0); PG8_MMA(0, 1, At, B1); PG8_BAR; PG8_SCHED;
            PG8_LDA(At, 1, 1); PG8_STAGE(PG8_SB(1, 0), b3, voffB); PG8_STAGE(PG8_SB(1, 1), b3 + hstepB, voffB); PG8_STAGE(PG8_SA(1, 0), a3, voffA);
            PG8_WAIT_V(8); PG8_WAIT_L(0); PG8_BAR; PG8_MMA(1, 0, At, B0); PG8_MMA(1, 1, At, B1); PG8_BAR; PG8_SCHED;
        }
        if constexpr (ALIGN_EPI) { if (wr == 0) PG8_BAR; }
        E(acc, cur, wr, wc, fr, fq);
        if (!has_next) break;
#pragma unroll
        for (int a = 0; a < 2; ++a)
#pragma unroll
            for (int b = 0; b < 2; ++b)
#pragma unroll
                for (int m = 0; m < 4; ++m)
#pragma unroll
                    for (int n = 0; n < 2; ++n) acc[a][b][m][n] = (f32x4){0.f, 0.f, 0.f, 0.f};
        cur = nxt; cA = nA; cB = nB; ++ui;
        if constexpr (ALIGN_EPI) { if (wr == 1) PG8_BAR; }
    }
    PG8_WAIT_V(0);
    if constexpr (!ALIGN_EPI) { if (wr == 0) PG8_BAR; }
    PG8_BAR;
#undef PG8_SA
#undef PG8_SB
#undef PG8_STAGE
#undef PG8_LDA
#undef PG8_LDB
#undef PG8_MMA
#undef PG8_WAIT_V
#undef PG8_WAIT_L
#undef PG8_BAR
#undef PG8_SCHED
}
}

constexpr int NWAVES = 8;
constexpr int BATCH = 4, SEQ = 8192, D = 1024, FF = 4096, NIN = 7 * D;
constexpr int M = BATCH * SEQ;
constexpr float LN_EPS = 1e-5f;
constexpr float ALPHA = 1.189207115002721f;
constexpr int TT = 32;
constexpr size_t MiB = 1u << 20;
constexpr size_t WS_CTL = 0; constexpr int CW_BAR = 4096, CTL_WORDS = 16384;
constexpr size_t WS_WIN = 1 * MiB, WS_WAB = 15 * MiB, WS_WO = 19 * MiB, WS_WUP = 21 * MiB, WS_WDN = 29 * MiB;
constexpr size_t WS_XB = 40 * MiB;
constexpr size_t WS_BA = 104 * MiB, WS_CV = 168 * MiB, WS_U0 = 232 * MiB, WS_SGA = 296 * MiB, WS_SGB = 360 * MiB;
constexpr size_t WS_T = 104 * MiB;
constexpr size_t WS_MG = 40 * MiB;
constexpr size_t WS_X1B = 104 * MiB;
constexpr size_t WS_H = 168 * MiB;
constexpr size_t WS_END = 424 * MiB;
constexpr int LDS_BYTES = 147456;
constexpr int MISC_OFF = LDS_BYTES - 128;

#define GAS __attribute__((address_space(1)))
#define LAS __attribute__((address_space(3)))
typedef unsigned short bf16;
typedef unsigned v4u __attribute__((ext_vector_type(4)));
typedef unsigned v2u __attribute__((ext_vector_type(2)));
typedef float f32x4 __attribute__((ext_vector_type(4)));
typedef float f32x2 __attribute__((ext_vector_type(2)));
#define LDS_WAIT() asm volatile("s_waitcnt lgkmcnt(0)" ::: "memory")
__device__ __forceinline__ unsigned f2bf(float f) { unsigned u = __builtin_bit_cast(unsigned, f); return (u + 0x7fffu + ((u >> 16) & 1u)) >> 16; }
__device__ __forceinline__ unsigned pk2(float lo, float hi) { return f2bf(lo) | (f2bf(hi) << 16); }

#define RLX_AGENT __ATOMIC_RELAXED, __HIP_MEMORY_SCOPE_AGENT
#define XB_TMO      128
#define XB_XCNT(j)  (256  + 64 * (j))
#define XB_XSUB(j)  (1280 + 64 * (j))
#define XB_XGEN(j)  (2304 + 64 * (j))
#define XB_TOP      3328
#define XB_TOPGEN   3392
#define XCD_BAR_WORDS 3456
#define XB_SPIN_CAP (1u << 18)

__device__ __forceinline__ unsigned xb_ld(unsigned* p)              { return __hip_atomic_load(p, __ATOMIC_RELAXED, __HIP_MEMORY_SCOPE_AGENT); }
__device__ __forceinline__ unsigned xb_add(unsigned* p, unsigned v) { return __hip_atomic_fetch_add(p, v, __ATOMIC_RELAXED, __HIP_MEMORY_SCOPE_AGENT); }
__device__ __forceinline__ unsigned xb_xcc_id() { return (unsigned)__builtin_amdgcn_s_getreg((3 << 11) | 20) & 0xFu; }
#define XB_SPIN(cond, bar) do { unsigned _sp = 0; while (cond) { __builtin_amdgcn_s_sleep(1); \
    if ((++_sp & 255u) == 0u) { if (xb_ld(&(bar)[XB_TMO])) break; if (_sp > XB_SPIN_CAP) { atomicAdd(&(bar)[XB_TMO], 1u); break; } } } } while (0)

struct XcdBarrier {
    unsigned* bar; unsigned x;
    volatile LAS unsigned* st;
};

__device__ __forceinline__ XcdBarrier xcd_barrier_post(unsigned* bar, volatile LAS unsigned* st) {
    XcdBarrier b; b.bar = bar; b.x = xb_xcc_id(); b.st = st;
    if (threadIdx.x == 0) (void)xb_add(&bar[XB_XCNT(b.x)], 1u);
    return b;
}
__device__ __forceinline__ void xcd_barrier_complete(unsigned* bar, unsigned x, unsigned& nloc, unsigned& nx) {
    const unsigned G = gridDim.x * gridDim.y * gridDim.z;
    unsigned sum, cnt, mine, sp = 0u;
    for (;;) {
        sum = 0u; cnt = 0u; mine = 0u;
#pragma unroll
        for (unsigned j = 0; j < 16; ++j) { const unsigned c = xb_ld(&bar[XB_XCNT(j)]); sum += c; cnt += (c > 0u) ? 1u : 0u; mine = (j == x) ? c : mine; }
        if (sum == G) break;
        __builtin_amdgcn_s_sleep(1);
        if ((++sp & 255u) == 0u) { if (xb_ld(&bar[XB_TMO])) break; if (sp > XB_SPIN_CAP) { atomicAdd(&bar[XB_TMO], 1u); break; } }
    }
    nloc = mine > 0u ? mine : 1u; nx = cnt > 0u ? cnt : 1u;
}

__device__ __forceinline__ void xcd_barrier(const XcdBarrier& b) {
    asm volatile("s_waitcnt vmcnt(0)" ::: "memory");
    __syncthreads();
    if (threadIdx.x == 0) {
        unsigned* bar = b.bar;
        __builtin_amdgcn_s_waitcnt(0);
        unsigned nloc = b.st[0], nx = b.st[1];
        if (nloc == 0u) { xcd_barrier_complete(bar, b.x, nloc, nx); b.st[0] = nloc; b.st[1] = nx; }
        const unsigned old = xb_add(&bar[XB_XSUB(b.x)], 1u);
        const unsigned gen = old / nloc;
        if (old + 1u == (gen + 1u) * nloc) {
            __builtin_amdgcn_fence(__ATOMIC_RELEASE, "agent");
            asm volatile("s_waitcnt vmcnt(0)" ::: "memory");
            const unsigned og = xb_add(&bar[XB_TOP], 1u);
            const unsigned tg = og / nx;
            if (og + 1u == (tg + 1u) * nx) xb_add(&bar[XB_TOPGEN], 1u);
            else XB_SPIN(xb_ld(&bar[XB_TOPGEN]) == tg, bar);
            __builtin_amdgcn_fence(__ATOMIC_ACQUIRE, "agent");
            xb_add(&bar[XB_XGEN(b.x)], 1u);
            asm volatile("s_waitcnt vmcnt(0)" ::: "memory");
        } else {
            XB_SPIN(xb_ld(&bar[XB_XGEN(b.x)]) == gen, bar);
            __builtin_amdgcn_fence(__ATOMIC_ACQUIRE, "agent");
            asm volatile("s_waitcnt vmcnt(0)" ::: "memory");
        }
    }
    __syncthreads();
}

struct Frame {
    LAS unsigned char* lds;
    int tid, lane, wave, vcu, G;
    const float *x, *w_in, *conv_a_w, *w_out_a, *conv_b_w, *conv_b_bias, *lnb_g, *lnb_b, *w_out_b, *w_o, *ln1_g, *ln1_b, *w_up, *w_down, *ln2_g, *ln2_b;
    float* out;
    bf16 *WIN, *WAB, *WO, *WUP, *WDN, *XB, *BA, *CV, *U0, *SGA, *SGB, *MG, *X1B, *HB;
    float* T;
};

__device__ __forceinline__ float wave_sum(float v) {
#pragma unroll
    for (int o = 1; o < 64; o <<= 1) v += __shfl_xor(v, o);
    return v;
}
__device__ __forceinline__ void p0_transpose_item(const float* W, int N, bf16* WT, int ldt, int koff, int k0, int n0, int drow0, LAS float* scr, int lane) {
#pragma unroll 8
    for (int i = 0; i < 32; ++i) { const int kk = 2 * i + (lane >> 5); scr[kk * 33 + (lane & 31)] = W[(size_t)(k0 + kk) * N + n0 + (lane & 31)]; }
    LDS_WAIT(); asm volatile("" ::: "memory");
    const int c = lane & 7;
#pragma unroll
    for (int j = 0; j < 4; ++j) { const int n = (lane >> 3) + 8 * j; const LAS float* s = scr + (8 * c) * 33 + n;
        v4u o; o.x = pk2(s[0 * 33], s[1 * 33]); o.y = pk2(s[2 * 33], s[3 * 33]); o.z = pk2(s[4 * 33], s[5 * 33]); o.w = pk2(s[6 * 33], s[7 * 33]);
        *(GAS v4u*)(WT + (size_t)(drow0 + n) * ldt + koff + k0 + 8 * c) = o; }
    LDS_WAIT(); asm volatile("" ::: "memory");
}
__device__ __forceinline__ int win_row(int n0) {
    const int seg = n0 >> 10, j = n0 & 1023;
    if (seg == 0) return j;
    if (seg == 1) return 1024 + (j >> 7) * 256 + (j & 127);
    if (seg == 2) return 1024 + (j >> 7) * 256 + 128 + (j & 127);
    if (seg == 3) return 3072 + (j >> 7) * 256 + (j & 127);
    if (seg == 4) return 3072 + (j >> 7) * 256 + 128 + (j & 127);
    if (seg == 5) return 5120 + j;
    return 6144 + j;
}
__device__ __forceinline__ void p0_prologue(Frame& F) {
    LAS float* scr = (LAS float*)(F.lds + F.wave * 16384);
    const int gw = F.vcu * NWAVES + F.wave, NGW = F.G * NWAVES;
    constexpr int I_IN = (D / 64) * (NIN / 32), I_SQ = (D / 64) * (D / 32), I_UP = (D / 64) * (FF / 32), I_DN = (FF / 64) * (D / 32);
    constexpr int NITEMS = I_IN + 3 * I_SQ + I_UP + I_DN;
    for (int it = gw; it < NITEMS; it += NGW) {
        int r = it;
        if (r < I_IN) { const int nb = NIN / 32, k0 = 64 * (r / nb), n0 = 32 * (r % nb); p0_transpose_item(F.w_in, NIN, F.WIN, D, 0, k0, n0, win_row(n0), scr, F.lane); continue; } r -= I_IN;
        if (r < I_SQ) { const int nb = D / 32, k0 = 64 * (r / nb), n0 = 32 * (r % nb); p0_transpose_item(F.w_out_a, D, F.WAB, 2 * D, 0, k0, n0, n0, scr, F.lane); continue; } r -= I_SQ;
        if (r < I_SQ) { const int nb = D / 32, k0 = 64 * (r / nb), n0 = 32 * (r % nb); p0_transpose_item(F.w_out_b, D, F.WAB, 2 * D, D, k0, n0, n0, scr, F.lane); continue; } r -= I_SQ;
        if (r < I_SQ) { const int nb = D / 32, k0 = 64 * (r / nb), n0 = 32 * (r % nb); p0_transpose_item(F.w_o, D, F.WO, D, 0, k0, n0, n0, scr, F.lane); continue; } r -= I_SQ;
        if (r < I_UP) { const int nb = FF / 32, k0 = 64 * (r / nb), n0 = 32 * (r % nb); p0_transpose_item(F.w_up, FF, F.WUP, D, 0, k0, n0, n0, scr, F.lane); continue; } r -= I_UP;
        { const int nb = D / 32, k0 = 64 * (r / nb), n0 = 32 * (r % nb); p0_transpose_item(F.w_down, D, F.WDN, FF, 0, k0, n0, n0, scr, F.lane); }
    }
    const size_t ngrp = (size_t)M * D / 8, nthr = (size_t)F.G * NWAVES * 64;
    for (size_t i = (size_t)blockIdx.x * (NWAVES * 64) + F.tid; i < ngrp; i += nthr) {
        const f32x4 a = *(const GAS f32x4*)(F.x + i * 8), b = *(const GAS f32x4*)(F.x + i * 8 + 4);
        v4u o; o.x = pk2(a[0], a[1]); o.y = pk2(a[2], a[3]); o.z = pk2(b[0], b[1]); o.w = pk2(b[2], b[3]);
        *(GAS v4u*)(F.XB + i * 8) = o;
    }
}


template <int R> struct ConvRows {
    static __device__ __forceinline__ void run(f32x2 (&acc)[TT], const f32x2 (&wb)[31], const GAS unsigned* up, bool first) {
        unsigned raw = 0u;
        if (R >= 30 || !first) raw = up[(ptrdiff_t)(R - 30) * (D / 2)];
        const f32x2 xv = (f32x2){__uint_as_float(raw << 16), __uint_as_float(raw & 0xffff0000u)};
        constexpr int TLO = R > 30 ? R - 30 : 0, THI = R < TT - 1 ? R : TT - 1;
#pragma unroll
        for (int t = TLO; t <= THI; ++t) acc[t] = acc[t] + wb[R - t] * xv;
        ConvRows<R + 1>::run(acc, wb, up, first);
    }
};
template <> struct ConvRows<TT + 30> { static __device__ __forceinline__ void run(f32x2 (&)[TT], const f32x2 (&)[31], const GAS unsigned*, bool) {} };

__device__ __forceinline__ void p2_mixers(Frame& F, bf16* YU) {
    const int tid = F.tid;
    f32x2 wb[31];
#pragma unroll
    for (int k = 0; k < 31; ++k) wb[k] = *(const GAS f32x2*)(F.conv_b_w + k * D + 2 * tid);
    const f32x2 bias = *(const GAS f32x2*)(F.conv_b_bias + 2 * tid), gam = *(const GAS f32x2*)(F.lnb_g + 2 * tid), bet = *(const GAS f32x2*)(F.lnb_b + 2 * tid);
    const f32x2 wa0 = *(const GAS f32x2*)(F.conv_a_w + 2 * tid), wa1 = *(const GAS f32x2*)(F.conv_a_w + D + 2 * tid), wa2 = *(const GAS f32x2*)(F.conv_a_w + 2 * D + 2 * tid);
    LAS float* red = (LAS float*)F.lds;
    LAS float* stats = red + 2 * TT * 520;
    for (int ch = blockIdx.x; ch < M / TT; ch += F.G) {
        const int t0 = ch * TT; const bool first = (t0 % SEQ) == 0;
        f32x2 acc[TT];
#pragma unroll
        for (int t = 0; t < TT; ++t) acc[t] = bias;
        const GAS unsigned* up = (const GAS unsigned*)F.U0 + ((size_t)t0 * (D / 2) + tid);
        ConvRows<0>::run(acc, wb, up, first);
#pragma unroll
        for (int t = 0; t < TT; ++t) { red[(2 * t) * 520 + tid] = acc[t].x + acc[t].y; red[(2 * t + 1) * 520 + tid] = acc[t].x * acc[t].x + acc[t].y * acc[t].y; }
        __syncthreads();
        {
            const int v = tid >> 3, seg = tid & 7; float a = 0.f;
#pragma unroll 16
            for (int i = 0; i < 64; ++i) a += red[v * 520 + seg + 8 * i];
            a += __shfl_xor(a, 1); a += __shfl_xor(a, 2); a += __shfl_xor(a, 4);
            const float other = __shfl_xor(a, 8);
            if ((tid & 15) == 0) { const float mean = a * (1.f / D); const float var = fmaxf(other * (1.f / D) - mean * mean, 0.f); stats[v] = mean; stats[v + 1] = 1.0f / sqrtf(var + LN_EPS); }
        }
        __syncthreads();
        GAS unsigned* yb = (GAS unsigned*)YU + ((size_t)t0 * D + D / 2 + tid);
#pragma unroll
        for (int t = 0; t < TT; ++t) { const float mean = stats[2 * t], rstd = stats[2 * t + 1];
            f32x2 y = (acc[t] - mean) * rstd * gam + bet;
            y.x = y.x * pg8::sigm(y.x); y.y = y.y * pg8::sigm(y.y);
            yb[(size_t)t * D] = pk2(y.x, y.y); }
        const GAS unsigned* cp = (const GAS unsigned*)F.CV + ((size_t)t0 * (D / 2) + tid);
        const GAS unsigned* bp = (const GAS unsigned*)F.BA + ((size_t)t0 * (D / 2) + tid);
        GAS unsigned* ya = (GAS unsigned*)YU + ((size_t)t0 * D + tid);
        unsigned r2 = 0u, r1 = 0u;
        if (!first) { r2 = cp[-(ptrdiff_t)(2 * (D / 2))]; r1 = cp[-(ptrdiff_t)(D / 2)]; }
        f32x2 c2 = (f32x2){__uint_as_float(r2 << 16), __uint_as_float(r2 & 0xffff0000u)}, c1 = (f32x2){__uint_as_float(r1 << 16), __uint_as_float(r1 & 0xffff0000u)};
#pragma unroll 8
        for (int t = 0; t < TT; ++t) { const unsigned rc = cp[(size_t)t * (D / 2)], rb = bp[(size_t)t * (D / 2)];
            const f32x2 c0 = (f32x2){__uint_as_float(rc << 16), __uint_as_float(rc & 0xffff0000u)}, b = (f32x2){__uint_as_float(rb << 16), __uint_as_float(rb & 0xffff0000u)};
            const f32x2 y = b * (wa0 * c2 + wa1 * c1 + wa2 * c0);
            ya[(size_t)t * D] = pk2(y.x, y.y); c2 = c1; c1 = c0; }
    }
}

__device__ __forceinline__ void ln_rows(Frame& F, const float* src, const float* gamma, const float* beta, float* dstf, bf16* dstb) {
    const int gw = F.vcu * NWAVES + F.wave, NGW = F.G * NWAVES;
    f32x4 g[4], b[4];
#pragma unroll
    for (int j = 0; j < 4; ++j) { g[j] = *((const GAS f32x4*)gamma + F.lane + 64 * j); b[j] = *((const GAS f32x4*)beta + F.lane + 64 * j); }
    for (int m = gw; m < M; m += NGW) {
        const GAS f32x4* xr = (const GAS f32x4*)(src + (size_t)m * D) + F.lane;
        f32x4 v[4]; float s = 0.f;
#pragma unroll
        for (int j = 0; j < 4; ++j) { v[j] = xr[64 * j]; s += (v[j].x + v[j].y) + (v[j].z + v[j].w); }
        const float mean = wave_sum(s) * (1.f / D); float s2 = 0.f;
#pragma unroll
        for (int j = 0; j < 4; ++j) { v[j] = v[j] - mean; s2 += (v[j].x * v[j].x + v[j].y * v[j].y) + (v[j].z * v[j].z + v[j].w * v[j].w); }
        const float rstd = 1.f / sqrtf(wave_sum(s2) * (1.f / D) + LN_EPS);
        GAS f32x4* of = (GAS f32x4*)(dstf + (size_t)m * D) + F.lane;
#pragma unroll
        for (int j = 0; j < 4; ++j) { v[j] = v[j] * rstd * g[j] + b[j]; of[64 * j] = v[j]; }
        if (dstb) { GAS v2u* ob = (GAS v2u*)(dstb + (size_t)m * D) + F.lane;
#pragma unroll
            for (int j = 0; j < 4; ++j) { v2u w; w.x = pk2(v[j].x, v[j].y); w.y = pk2(v[j].z, v[j].w); ob[64 * j] = w; } }
    }
}

struct Args { const float* in[16]; float* out; unsigned char* ws; };

__global__ void __launch_bounds__(NWAVES * 64, 2) mega_fwd(Args args) {
    extern __shared__ __attribute__((aligned(16))) unsigned char lds[];
    cg::grid_group grid = cg::this_grid();
    Frame F;
    F.lds = (LAS unsigned char*)lds;
    F.tid = threadIdx.x; F.lane = F.tid & 63; F.wave = __builtin_amdgcn_readfirstlane(F.tid >> 6);
    F.G = gridDim.x; { const int bx = blockIdx.x; F.vcu = (F.G % 8 == 0) ? (bx % 8) * (F.G / 8) + bx / 8 : bx; }
    unsigned char* ws = args.ws;
    F.x = args.in[0]; F.w_in = args.in[1]; F.conv_a_w = args.in[2]; F.w_out_a = args.in[3]; F.conv_b_w = args.in[4]; F.conv_b_bias = args.in[5];
    F.lnb_g = args.in[6]; F.lnb_b = args.in[7]; F.w_out_b = args.in[8]; F.w_o = args.in[9]; F.ln1_g = args.in[10]; F.ln1_b = args.in[11];
    F.w_up = args.in[12]; F.w_down = args.in[13]; F.ln2_g = args.in[14]; F.ln2_b = args.in[15]; F.out = args.out;
    F.WIN = (bf16*)(ws + WS_WIN); F.WAB = (bf16*)(ws + WS_WAB); F.WO = (bf16*)(ws + WS_WO); F.WUP = (bf16*)(ws + WS_WUP); F.WDN = (bf16*)(ws + WS_WDN);
    F.XB = (bf16*)(ws + WS_XB); F.BA = (bf16*)(ws + WS_BA); F.CV = (bf16*)(ws + WS_CV); F.U0 = (bf16*)(ws + WS_U0); F.SGA = (bf16*)(ws + WS_SGA); F.SGB = (bf16*)(ws + WS_SGB);
    F.MG = (bf16*)(ws + WS_MG); F.X1B = (bf16*)(ws + WS_X1B); F.HB = (bf16*)(ws + WS_H); F.T = (float*)(ws + WS_T);
    bf16* YU = (bf16*)F.out;

    unsigned* ctl = (unsigned*)(ws + WS_CTL);
    if (blockIdx.x == 0) for (int i = F.tid; i < CTL_WORDS; i += NWAVES * 64) ctl[i] = 0u;
    if (F.tid < 32) ((volatile LAS unsigned*)(F.lds + MISC_OFF))[F.tid] = 0u;
    p0_prologue(F);
    grid.sync();
    const XcdBarrier bar = xcd_barrier_post(ctl + CW_BAR, (volatile LAS unsigned*)(F.lds + MISC_OFF));
    { pg8::Gemm g{F.XB, F.WIN, M, NIN, D, D, D}; pg8::StaticOrder S; S.init(M, NIN, F.G, (int)blockIdx.x);
      pg8::EpiP1 E{F.BA, (size_t)(WS_CV - WS_BA) / 2, D};
      static_assert(WS_CV - WS_BA == WS_U0 - WS_CV && WS_U0 - WS_CV == WS_SGA - WS_U0 && WS_SGA - WS_U0 == WS_SGB - WS_SGA, "P1 outputs equally spaced");
      pg8::gemm_phase<pg8::EpiP1, pg8::StaticOrder, true>(F.lds, g, S, E); }
    xcd_barrier(bar);
    p2_mixers(F, YU);
    xcd_barrier(bar);
    { pg8::Gemm g{YU, F.WAB, M, D, D, 2 * D, 2 * D}; pg8::StaticOrder S; S.init(M, D, F.G, (int)blockIdx.x);
      pg8::EpiGateA E{F.SGA, F.T, D};
      pg8::gemm_phase<pg8::EpiGateA, pg8::StaticOrder, true>(F.lds, g, S, E); }
    xcd_barrier(bar);
    { pg8::Gemm g{YU + D, F.WAB + D, M, D, D, 2 * D, 2 * D}; pg8::StaticOrder S; S.init(M, D, F.G, (int)blockIdx.x);
      pg8::EpiGateB E{F.SGB, F.T, F.MG, D};
      pg8::gemm_phase<pg8::EpiGateB, pg8::StaticOrder, true>(F.lds, g, S, E); }
    xcd_barrier(bar);
    { pg8::Gemm g{F.MG, F.WO, M, D, D, D, D}; pg8::StaticOrder S; S.init(M, D, F.G, (int)blockIdx.x);
      pg8::EpiRes E{F.x, F.out, D, ALPHA};
      pg8::gemm_phase<pg8::EpiRes, pg8::StaticOrder, true>(F.lds, g, S, E); }
    xcd_barrier(bar);
    ln_rows(F, F.out, F.ln1_g, F.ln1_b, F.out, F.X1B);
    xcd_barrier(bar);
    { pg8::Gemm g{F.X1B, F.WUP, M, FF, D, D, D}; pg8::StaticOrder S; S.init(M, FF, F.G, (int)blockIdx.x);
      pg8::EpiRelu2 E{F.HB, FF};
      pg8::gemm_phase<pg8::EpiRelu2, pg8::StaticOrder, true>(F.lds, g, S, E); }
    xcd_barrier(bar);
    { pg8::Gemm g{F.HB, F.WDN, M, D, FF, FF, FF}; pg8::StaticOrder S; S.init(M, D, F.G, (int)blockIdx.x);
      pg8::EpiRes E{F.out, F.out, D, ALPHA};
      pg8::gemm_phase<pg8::EpiRes, pg8::StaticOrder, true>(F.lds, g, S, E); }
    xcd_barrier(bar);
    ln_rows(F, F.out, F.ln2_g, F.ln2_b, F.out, nullptr);
}

extern "C" void kernel_launch(void* const* d_in, const int* in_sizes, int n_in, void* d_out, int out_size, void* d_ws, size_t ws_size, hipStream_t stream) {
    static int grid = 0;
    if (grid == 0) {
        if (n_in != 16 || in_sizes[0] != M * D || out_size != M * D || ws_size < WS_END) { fprintf(stderr, "kernel_launch: unexpected shapes (n_in %d, in0 %d, out %d, ws %zu)\n", n_in, n_in > 0 ? in_sizes[0] : -1, out_size, ws_size); grid = -1; return; }
        int dev = 0, cus = 0, per_cu = 0;
        if (hipGetDevice(&dev) != hipSuccess || hipDeviceGetAttribute(&cus, hipDeviceAttributeMultiprocessorCount, dev) != hipSuccess) { grid = -1; return; }
        if (hipFuncSetAttribute((const void*)mega_fwd, hipFuncAttributeMaxDynamicSharedMemorySize, LDS_BYTES) != hipSuccess) { fprintf(stderr, "kernel_launch: hipFuncSetAttribute failed\n"); grid = -1; return; }
        if (hipOccupancyMaxActiveBlocksPerMultiprocessor(&per_cu, (const void*)mega_fwd, NWAVES * 64, LDS_BYTES) != hipSuccess || per_cu < 1) { fprintf(stderr, "kernel_launch: occupancy query failed (%d)\n", per_cu); (void)hipGetLastError(); per_cu = 1; }
        grid = cus * (per_cu > 1 ? 1 : per_cu);
    }
    if (grid < 0) return;
    Args a{};
    for (int i = 0; i < 16; ++i) a.in[i] = (const float*)d_in[i];
    a.out = (float*)d_out; a.ws = (unsigned char*)d_ws;
    void* kargs[] = {&a};
    hipError_t e = hipLaunchCooperativeKernel((const void*)mega_fwd, dim3(grid), dim3(NWAVES * 64), kargs, LDS_BYTES, stream);
    if (e != hipSuccess) fprintf(stderr, "kernel_launch: cooperative launch failed: %s (grid %d)\n", hipGetErrorString(e), grid);
}
```
